# Optimizing an MI355X kernel written in HIP

```python
import math
import jax, jax.numpy as jnp
from jax import lax
import numpy as np


D_MODEL = 2048
BATCH = 8
SEQ = 2048
DEPTH = 1

A_HEADS = 8
A_HEAD_DIM = 128
A_WIDTH = A_HEADS * A_HEAD_DIM
MOBA_BLOCK = 256
MOBA_TOPK = 3
MOBA_Q_CHUNK = 16
REL_BUCKETS = 32
REL_MAX_DIST = 128
B_HEADS = 8
B_KEY_DIM = 128
B_VAL_DIM = 128
B_KW = B_HEADS * B_KEY_DIM
B_VW = B_HEADS * B_VAL_DIM
CONV_WIDTH = 4
DELTA_CHUNK = 64
PEER_HEADS = 8
PEER_NKEYS = 128
PEER_EXPERTS = PEER_NKEYS * PEER_NKEYS
PEER_QDIM = 256
PEER_TOPK = 16
PEER_TOK_CHUNK = 128
EPS = 1e-6
IN_SIZES = (A_WIDTH, A_WIDTH, A_WIDTH, 2 * B_KW + B_VW, B_VW, B_HEADS, B_HEADS, D_MODEL, D_MODEL)
IN_TOTAL = 3 * A_WIDTH + 2 * B_KW + 2 * B_VW + 2 * B_HEADS + 2 * D_MODEL

kernel_name = 'hybrid_moba_gdn_peer_block'


def rms_norm(x, gain):
    xf = x.astype(jnp.float32)
    y = xf * lax.rsqrt(jnp.mean(xf * xf, axis=-1, keepdims=True) + EPS)
    return (y * gain.astype(jnp.float32)).astype(x.dtype)


def l2_norm(x):
    xf = x.astype(jnp.float32)
    return (xf * lax.rsqrt(jnp.sum(xf * xf, axis=-1, keepdims=True) + EPS)).astype(x.dtype)


def t5_bucket(rel):
    n = jnp.maximum(-rel, 0)
    max_exact = REL_BUCKETS // 2
    nf = jnp.maximum(n, 1).astype(jnp.float32)
    large = max_exact + (jnp.log(nf / max_exact) / math.log(REL_MAX_DIST / max_exact)
                         * (REL_BUCKETS - max_exact)).astype(jnp.int32)
    large = jnp.minimum(large, REL_BUCKETS - 1)
    return jnp.where(n < max_exact, n, large)


def moba_attention(q, k, v, rel_bias):
    B, H, S, dh = q.shape
    nb = -(-S // MOBA_BLOCK)
    pad = nb * MOBA_BLOCK - S
    kb = jnp.pad(k, ((0, 0), (0, 0), (0, pad), (0, 0))).reshape(B, H, nb, MOBA_BLOCK, dh)
    vb = jnp.pad(v, ((0, 0), (0, 0), (0, pad), (0, 0))).reshape(B, H, nb, MOBA_BLOCK, dh)
    kmean = jnp.mean(kb.astype(jnp.float32), axis=3)
    qblk = jnp.arange(S) // MOBA_BLOCK
    gate = jnp.einsum('bhsd,bhnd->bhsn', q.astype(jnp.float32), kmean)
    past = jnp.arange(nb)[None, :] < qblk[:, None]
    gate = jnp.where(past, gate, -jnp.inf)
    topk = min(MOBA_TOPK, nb)
    gsel, sel = lax.top_k(gate, topk)
    valid = jnp.isfinite(gsel)
    bi = jnp.arange(B)[:, None, None, None]
    hi = jnp.arange(H)[None, :, None, None]
    offs = jnp.arange(MOBA_BLOCK)
    scale = dh ** -0.5
    bias_hb = rel_bias.T.astype(jnp.float32)
    QC = MOBA_Q_CHUNK

    def one_chunk(c):
        start = c * QC
        qc = lax.dynamic_slice_in_dim(q, start, QC, axis=2)
        selc = lax.dynamic_slice_in_dim(sel, start, QC, axis=2)
        validc = lax.dynamic_slice_in_dim(valid, start, QC, axis=2)
        qpos = start + jnp.arange(QC)
        own = start // MOBA_BLOCK
        k_sel = kb[bi, hi, selc]
        v_sel = vb[bi, hi, selc]
        s_sel = jnp.einsum('bhqd,bhqkjd->bhqkj', qc, k_sel).astype(jnp.float32) * scale
        kpos_sel = selc[..., None] * MOBA_BLOCK + offs
        bias_sel = bias_hb[hi[..., None], t5_bucket(kpos_sel - qpos[None, None, :, None, None])]
        s_sel = jnp.where(validc[..., None], s_sel + bias_sel, -jnp.inf).reshape(B, H, QC, topk * MOBA_BLOCK)
        k_own = lax.dynamic_index_in_dim(kb, own, axis=2, keepdims=False)
        v_own = lax.dynamic_index_in_dim(vb, own, axis=2, keepdims=False)
        rel_own = (own * MOBA_BLOCK + offs)[None, :] - qpos[:, None]
        s_own = (jnp.einsum('bhqd,bhjd->bhqj', qc, k_own).astype(jnp.float32) * scale
                 + bias_hb[:, t5_bucket(rel_own)][None])
        s_own = jnp.where(rel_own <= 0, s_own, -jnp.inf)
        p = jax.nn.softmax(jnp.concatenate([s_sel, s_own], axis=-1), axis=-1)
        p_sel = p[..., :topk * MOBA_BLOCK].reshape(B, H, QC, topk, MOBA_BLOCK).astype(v.dtype)
        p_own = p[..., topk * MOBA_BLOCK:].astype(v.dtype)
        return (jnp.einsum('bhqkj,bhqkjd->bhqd', p_sel, v_sel)
                + jnp.einsum('bhqj,bhjd->bhqd', p_own, v_own))

    out = lax.map(one_chunk, jnp.arange(S // QC))
    return out.transpose(1, 2, 0, 3, 4).reshape(B, H, S, dh)


def causal_depthwise_conv(x, w):
    C = x.shape[-1]
    return lax.conv_general_dilated(x, w[:, None, :].astype(x.dtype), window_strides=(1,),
                                    padding=[(CONV_WIDTH - 1, 0)],
                                    dimension_numbers=('NWC', 'WIO', 'NWC'),
                                    feature_group_count=C)


def gated_delta_rule(q, k, v, g, beta):
    B, H, S, dk = q.shape
    dv = v.shape[-1]
    C = DELTA_CHUNK
    N = S // C
    f32 = jnp.float32
    qc = (q.astype(f32) * dk ** -0.5).reshape(B, H, N, C, dk)
    kc = k.astype(f32).reshape(B, H, N, C, dk)
    vc = v.astype(f32).reshape(B, H, N, C, dv)
    bc = beta.astype(f32).reshape(B, H, N, C)
    gcum = jnp.cumsum(g.astype(f32).reshape(B, H, N, C), axis=-1)
    idx = jnp.arange(C)
    causal = idx[:, None] >= idx[None, :]
    strict = idx[:, None] > idx[None, :]
    decay = jnp.exp(jnp.where(causal, gcum[..., :, None] - gcum[..., None, :], -jnp.inf))
    kbeta = kc * bc[..., None]
    vbeta = vc * bc[..., None]
    L = jnp.where(strict, jnp.einsum('bhnid,bhnjd->bhnij', kbeta, kc) * decay, 0.0)
    eye = jnp.eye(C, dtype=f32)
    T = lax.linalg.triangular_solve(eye + L, jnp.broadcast_to(eye, L.shape), left_side=True,
                                    lower=True, unit_diagonal=True)
    u = T @ vbeta
    w = T @ (kbeta * jnp.exp(gcum)[..., None])
    attn = jnp.einsum('bhnid,bhnjd->bhnij', qc, kc) * decay
    q_dec = qc * jnp.exp(gcum)[..., None]
    g_last = gcum[..., -1]
    k_dec = kc * jnp.exp(g_last[..., None] - gcum)[..., None]

    def step(state, inp):
        u_n, w_n, attn_n, qd_n, kd_n, gl_n = inp
        v_new = u_n - w_n @ state
        o = qd_n @ state + attn_n @ v_new
        state = state * jnp.exp(gl_n)[..., None, None] + jnp.swapaxes(kd_n, -1, -2) @ v_new
        return state, o

    xs = tuple(jnp.moveaxis(a, 2, 0) for a in (u, w, attn, q_dec, k_dec, g_last))
    s0 = jnp.zeros((B, H, dk, dv), f32)
    _, o = lax.scan(step, s0, xs)
    return o.transpose(1, 2, 0, 3, 4).reshape(B, H, S, dv)


def token_mixers(h, rel_bias, w_in, conv_w, a_log, dt_bias, q_norm_gain, k_norm_gain,
                 gdn_norm_gain, w_up_a, w_up_b, w_out):
    B, S, _ = h.shape
    proj = h @ w_in
    offsets = np.cumsum(IN_SIZES)[:-1].tolist()
    qa, ka, va, qkv_b, z_b, beta_raw, alpha_raw, gate_a, gate_b = jnp.split(proj, offsets, axis=-1)
    qa = rms_norm(qa.reshape(B, S, A_HEADS, A_HEAD_DIM), q_norm_gain).transpose(0, 2, 1, 3)
    ka = rms_norm(ka.reshape(B, S, A_HEADS, A_HEAD_DIM), k_norm_gain).transpose(0, 2, 1, 3)
    va = va.reshape(B, S, A_HEADS, A_HEAD_DIM).transpose(0, 2, 1, 3)
    o_a = moba_attention(qa, ka, va, rel_bias).transpose(0, 2, 1, 3).reshape(B, S, A_WIDTH)
    qkv_b = jax.nn.silu(causal_depthwise_conv(qkv_b, conv_w))
    qb, kb, vb = jnp.split(qkv_b, [B_KW, 2 * B_KW], axis=-1)
    qb = l2_norm(qb.reshape(B, S, B_HEADS, B_KEY_DIM)).transpose(0, 2, 1, 3)
    kb = l2_norm(kb.reshape(B, S, B_HEADS, B_KEY_DIM)).transpose(0, 2, 1, 3)
    vb = vb.reshape(B, S, B_HEADS, B_VAL_DIM).transpose(0, 2, 1, 3)
    beta = jax.nn.sigmoid(beta_raw.astype(jnp.float32)).transpose(0, 2, 1)
    g = (-jnp.exp(a_log.astype(jnp.float32))
         * jax.nn.softplus(alpha_raw.astype(jnp.float32) + dt_bias.astype(jnp.float32))).transpose(0, 2, 1)
    o_b = gated_delta_rule(qb, kb, vb, g, beta).astype(h.dtype).transpose(0, 2, 1, 3)
    o_b = rms_norm(o_b, gdn_norm_gain) * jax.nn.silu(z_b.reshape(B, S, B_HEADS, B_VAL_DIM))
    o_b = o_b.reshape(B, S, B_VW)
    merged = jax.nn.sigmoid(gate_a) * (o_a @ w_up_a) + jax.nn.sigmoid(gate_b) * (o_b @ w_up_b)
    return merged @ w_out


def peer_ffn(h, w_query, sub_keys, expert_down, expert_up):
    B, S, D = h.shape
    T = B * S
    K = PEER_TOPK
    ht = h.reshape(T, D)
    qry = (ht @ w_query).reshape(T, PEER_HEADS, 2, PEER_QDIM // 2)
    scores = jnp.einsum('thpd,hpkd->thpk', qry, sub_keys).astype(jnp.float32)
    s_top, i_top = lax.top_k(scores, K)
    cand = (s_top[:, :, 0, :, None] + s_top[:, :, 1, None, :]).reshape(T, PEER_HEADS, K * K)
    cand_idx = (i_top[:, :, 0, :, None] * PEER_NKEYS + i_top[:, :, 1, None, :]).reshape(T, PEER_HEADS, K * K)
    best, pos = lax.top_k(cand, K)
    expert_idx = jnp.take_along_axis(cand_idx, pos, axis=-1)
    gate = jax.nn.softmax(best, axis=-1)
    TC = PEER_TOK_CHUNK

    def one_chunk(c):
        start = c * TC
        hc = lax.dynamic_slice_in_dim(ht, start, TC, axis=0)
        ec = lax.dynamic_slice_in_dim(expert_idx, start, TC, axis=0)
        gc = lax.dynamic_slice_in_dim(gate, start, TC, axis=0)
        u = expert_down[ec]
        vv = expert_up[ec]
        act = jax.nn.gelu(jnp.einsum('td,thkd->thk', hc, u).astype(jnp.float32), approximate=False)
        return jnp.einsum('thk,thkd->td', (gc * act).astype(vv.dtype), vv)

    out = lax.map(one_chunk, jnp.arange(T // TC))
    return out.reshape(B, S, D)


def setup_inputs(seed: int = 0) -> dict:
    key = jax.random.key(seed)
    ks = jax.random.split(key, 20)
    f32 = jnp.float32

    def nrm(k, shape, scale):
        return jax.random.normal(k, shape, f32) * scale

    def gain(k, n):
        return 1.0 + 0.05 * jax.random.normal(k, (DEPTH, n), f32)

    dt = jnp.exp(jax.random.uniform(ks[6], (DEPTH, B_HEADS), f32, math.log(1e-3), math.log(1e-1)))
    return {
        'x': nrm(ks[0], (BATCH, SEQ, D_MODEL), 1.0),
        'rel_bias': nrm(ks[1], (REL_BUCKETS, A_HEADS), 0.5),
        'norm1_gain': gain(ks[2], D_MODEL),
        'w_in': nrm(ks[3], (DEPTH, D_MODEL, IN_TOTAL), D_MODEL ** -0.5),
        'conv_w': nrm(ks[4], (DEPTH, CONV_WIDTH, 2 * B_KW + B_VW), CONV_WIDTH ** -0.5),
        'a_log': jnp.log(jax.random.uniform(ks[5], (DEPTH, B_HEADS), f32, 1.0, 16.0)),
        'dt_bias': jnp.log(jnp.expm1(dt)),
        'q_norm_gain': gain(ks[7], A_HEAD_DIM),
        'k_norm_gain': gain(ks[8], A_HEAD_DIM),
        'gdn_norm_gain': gain(ks[9], B_VAL_DIM),
        'w_up_a': nrm(ks[10], (DEPTH, A_WIDTH, D_MODEL), A_WIDTH ** -0.5),
        'w_up_b': nrm(ks[11], (DEPTH, B_VW, D_MODEL), B_VW ** -0.5),
        'w_out': nrm(ks[12], (DEPTH, D_MODEL, D_MODEL), D_MODEL ** -0.5),
        'norm2_gain': gain(ks[13], D_MODEL),
        'peer_w_query': nrm(ks[14], (DEPTH, D_MODEL, PEER_HEADS * PEER_QDIM), D_MODEL ** -0.5),
        'peer_sub_keys': nrm(ks[15], (DEPTH, PEER_HEADS, 2, PEER_NKEYS, PEER_QDIM // 2), (PEER_QDIM // 2) ** -0.5),
        'peer_u': nrm(ks[16], (DEPTH, PEER_EXPERTS, D_MODEL), D_MODEL ** -0.5),
        'peer_v': nrm(ks[17], (DEPTH, PEER_EXPERTS, D_MODEL), PEER_HEADS ** -0.5),
    }


def reference(x, rel_bias, norm1_gain, w_in, conv_w, a_log, dt_bias, q_norm_gain, k_norm_gain,
              gdn_norm_gain, w_up_a, w_up_b, w_out, norm2_gain, peer_w_query, peer_sub_keys,
              peer_u, peer_v):
    for l in range(DEPTH):
        h = rms_norm(x, norm1_gain[l])
        x = x + token_mixers(h, rel_bias, w_in[l], conv_w[l], a_log[l], dt_bias[l], q_norm_gain[l],
                             k_norm_gain[l], gdn_norm_gain[l], w_up_a[l], w_up_b[l], w_out[l])
        h2 = rms_norm(x, norm2_gain[l])
        x = x + peer_ffn(h2, peer_w_query[l], peer_sub_keys[l], peer_u[l], peer_v[l])
    return x
```

```cpp
#include <hip/hip_runtime.h>
#include <hip/hip_cooperative_groups.h>
#include <cstdio>
namespace cg = cooperative_groups;

#define LAS __attribute__((address_space(3)))
#define DI __device__ __forceinline__
typedef unsigned short bf16;
typedef short bf16x8 __attribute__((ext_vector_type(8)));
typedef short bf16x4 __attribute__((ext_vector_type(4)));
typedef float f32x2 __attribute__((ext_vector_type(2)));
typedef float f32x4 __attribute__((ext_vector_type(4)));
typedef float f32x16 __attribute__((ext_vector_type(16)));
typedef unsigned u32x2 __attribute__((ext_vector_type(2)));
typedef unsigned u32x4 __attribute__((ext_vector_type(4)));
typedef __bf16 bf2_t __attribute__((ext_vector_type(2)));

DI unsigned pk2(float lo, float hi) { f32x2 v = {lo, hi}; bf2_t r = __builtin_convertvector(v, bf2_t); return __builtin_bit_cast(unsigned, r); }
DI bf16 f2bf(float f) { return (bf16)(pk2(f, 0.f) & 0xffffu); }
DI float bflo(unsigned w) { return __uint_as_float(w << 16); }
DI float bfhi(unsigned w) { return __uint_as_float(w & 0xffff0000u); }
DI float bf2f(bf16 b) { return __uint_as_float(((unsigned)b) << 16); }
DI float wave_sum(float v) {
#pragma unroll
    for (int o = 1; o < 64; o <<= 1) v += __shfl_xor(v, o);
    return v;
}
DI float sigmoidf_(float x) { return 1.f / (1.f + __expf(-x)); }
DI float siluf_(float x) { return x / (1.f + __expf(-x)); }
#define LDS_WAIT() asm volatile("s_waitcnt lgkmcnt(0)" ::: "memory")

constexpr int T = 16384, D = 2048, SEQ = 2048, NBATCH = 8, NH = 8, DH = 128;
constexpr int IN_TOTAL = 11280;
constexpr float EPS = 1e-6f;
constexpr float LOG2E = 1.4426950408889634f;

constexpr size_t MiB = 1u << 20;
constexpr size_t WS_CTL = 0;
constexpr size_t WS_RSTD1 = 1 * MiB;
constexpr size_t WS_SUMSQ2 = 1 * MiB + 65536;
constexpr size_t WS_KMEAN = 1 * MiB + 131072;
constexpr size_t WS_EGL = 1 * MiB + 393216;
constexpr size_t WS_BIAS = 1 * MiB + 401408;
constexpr size_t WS_WBAT = 1 * MiB + 409600;
constexpr size_t WS_BA = 2 * MiB;
constexpr size_t WS_WUPA = 4 * MiB, WS_WUPB = 8 * MiB, WS_WOUT = 12 * MiB, WS_WQ = 20 * MiB, WS_SK = 28 * MiB;
constexpr size_t WS_WINB = 32 * MiB;
constexpr size_t WS_XB = 48 * MiB;
constexpr size_t WS_WINA = 112 * MiB;
constexpr size_t WS_QKA = 140 * MiB;
constexpr size_t WS_VT = 204 * MiB;
constexpr size_t WS_QKVB = 236 * MiB;
constexpr size_t WS_ZB = 332 * MiB;
constexpr size_t WS_GW = 364 * MiB, WS_GQD = 396 * MiB, WS_GKDT = 428 * MiB, WS_GUT = 460 * MiB, WS_GATT = 492 * MiB;
constexpr size_t WS_OA = 236 * MiB, WS_OB = 268 * MiB;
constexpr size_t WS_G = 364 * MiB;
constexpr size_t WS_PP = 140 * MiB;
constexpr size_t WS_MERGED = 48 * MiB;
constexpr size_t WS_Y1B = 140 * MiB;
constexpr size_t WS_QRY = 48 * MiB;
constexpr size_t WS_UB = 236 * MiB, WS_VB = 300 * MiB;
constexpr size_t WS_EIDX = 204 * MiB;
constexpr size_t WS_GATEW = 208 * MiB;
constexpr size_t WS_END = 508 * MiB;

constexpr int LDS_BYTES = 147456;
#ifndef PSCALE
#define PSCALE 1.0f
#endif

namespace pg8 {
constexpr int BM = 256, BK = 64, HALF = 128, HTB = HALF * BK * 2, STAGE_BYTES = 8 * HTB, NXCD = 8, WGM = 8;
DI int lds_byte(int r, int c) { const int st = (r >> 4) * 2 + (c >> 5), rr = r & 15, cc = c & 31, ob = rr * 64 + cc * 2; return st * 1024 + (ob ^ (((ob >> 9) & 1) << 5)); }
DI void stage_rc(int b, int& R, int& C) { const int st = b / 1024, sb = b % 1024, swz = sb ^ (((sb >> 9) & 1) << 5); R = (st >> 1) * 16 + swz / 64; C = (st & 1) * 32 + (swz % 64) / 2; }
DI int perm32(int rho) { const int n = rho >> 4, i = rho & 15; return 8 * (i >> 2) + 4 * n + (i & 3); }
struct Unit { int pm, pn; };
struct Gemm { const bf16* A; const bf16* Bt; int M, N, K; };
struct StaticOrder {
    int nM, nN, nwg, G, c;
    DI void init(int M, int N, int G_, int c_) { nM = M / BM; nN = N / BM; nwg = nM * nN; G = G_; c = c_; }
    DI bool next(int i, Unit& u) const {
        const long L = (long)i * G + c; if (L >= nwg) return false;
        int wgid = (int)L; { const int q = nwg / NXCD, r = nwg % NXCD, xcd = wgid % NXCD, off = wgid / NXCD; wgid = (xcd < r ? xcd * (q + 1) : r * (q + 1) + (xcd - r) * q) + off; }
        const int nig = WGM * nN, gid = wgid / nig, fm = gid * WGM, gsz = (nM - fm) < WGM ? (nM - fm) : WGM;
        u.pm = fm + ((wgid % nig) % gsz); u.pn = (wgid % nig) / gsz; return true;
    }
};
template <class Epi>
DI void gemm_phase(LAS unsigned char* lds, const Gemm g, const StaticOrder& S, const Epi& E) {
    const int tid = threadIdx.x, wid = __builtin_amdgcn_readfirstlane(tid >> 6), lane = tid & 63, wr = wid >> 2, wc = wid & 3, fr = lane & 15, fq = lane >> 4;
    const int K = g.K, nt = K / BK;
    unsigned voffA[2], voffB[2];
#pragma unroll
    for (int i = 0; i < 2; ++i) { int R, C; stage_rc(tid * 16 + i * 8192, R, C); const int Rb = (R & ~31) + perm32(R & 31);
        voffA[i] = (unsigned)(R * K + C) * 2u; voffB[i] = (unsigned)(Rb * K + C) * 2u; }
    const size_t kstep = (size_t)(BK * 2);
    const size_t hstep = (size_t)HALF * K * 2;
    const size_t tstep = 2 * hstep;
    const unsigned ldsw = (unsigned)wid * 1024u;
    const int aoff = lds_byte(wr * 64 + fr, fq * 8), boff = lds_byte(wc * 32 + fr, fq * 8);
#define PG8_SA(b, h) (((b) * 2 + (h)) * HTB)
#define PG8_SB(b, h) ((4 + (b) * 2 + (h)) * HTB)
#define PG8_STAGE(bufoff, gbase, voff) do { _Pragma("unroll") for (int _i = 0; _i < 2; ++_i) \
        __builtin_amdgcn_global_load_lds((const unsigned*)((const char*)(gbase) + (voff)[_i]), (LAS unsigned*)(lds + (bufoff) + ldsw + _i * 8192), 16, 0, 0); } while (0)
#define PG8_LDA(dst, b, h) do { _Pragma("unroll") for (int m = 0; m < 4; ++m) _Pragma("unroll") for (int k = 0; k < 2; ++k) dst[m][k] = *(const LAS bf16x8*)(lds + PG8_SA(b, h) + aoff + m * 2048 + k * 1024); } while (0)
#define PG8_LDB(dst, b, h) do { _Pragma("unroll") for (int n = 0; n < 2; ++n) _Pragma("unroll") for (int k = 0; k < 2; ++k) dst[n][k] = *(const LAS bf16x8*)(lds + PG8_SB(b, h) + boff + n * 2048 + k * 1024); } while (0)
#define PG8_MMA(ai, bj, At, Bt) do { __builtin_amdgcn_s_setprio(1); _Pragma("unroll") for (int m = 0; m < 4; ++m) _Pragma("unroll") for (int n = 0; n < 2; ++n) _Pragma("unroll") for (int k = 0; k < 2; ++k) \
        acc[ai][bj][m][n] = __builtin_amdgcn_mfma_f32_16x16x32_bf16(Bt[n][k], At[m][k], acc[ai][bj][m][n], 0, 0, 0); __builtin_amdgcn_s_setprio(0); } while (0)
#define PG8_WAIT_V(n) asm volatile("s_waitcnt vmcnt(" #n ")" ::: "memory")
#define PG8_WAIT_L(n) asm volatile("s_waitcnt lgkmcnt(" #n ")" ::: "memory")
#define PG8_BAR __builtin_amdgcn_s_barrier()
#define PG8_SCHED __builtin_amdgcn_sched_barrier(0)
    Unit cur, nxt; int ui = 0;
    if (!S.next(0, cur)) return;
    f32x4 acc[2][2][4][2];
#pragma unroll
    for (int a = 0; a < 2; ++a)
#pragma unroll
        for (int b = 0; b < 2; ++b)
#pragma unroll
            for (int m = 0; m < 4; ++m)
#pragma unroll
                for (int n = 0; n < 2; ++n) acc[a][b][m][n] = (f32x4){0.f, 0.f, 0.f, 0.f};
    bf16x8 At[4][2], B0[2][2], B1[2][2];
    const char* cA = (const char*)g.A + (size_t)cur.pm * tstep; const char* cB = (const char*)g.Bt + (size_t)cur.pn * tstep;
    PG8_STAGE(PG8_SB(0, 0), cB, voffB); PG8_STAGE(PG8_SA(0, 0), cA, voffA); PG8_STAGE(PG8_SB(0, 1), cB + hstep, voffB); PG8_STAGE(PG8_SA(0, 1), cA + hstep, voffA);
    if (wr == 1) PG8_BAR;
    PG8_WAIT_V(4); PG8_BAR;
    PG8_STAGE(PG8_SB(1, 0), cB + kstep, voffB); PG8_STAGE(PG8_SA(1, 0), cA + kstep, voffA); PG8_STAGE(PG8_SB(1, 1), cB + hstep + kstep, voffB);
    PG8_WAIT_V(6); PG8_BAR;
    for (;;) {
        const bool has_next = S.next(ui + 1, nxt);
        const char* nA = has_next ? (const char*)g.A + (size_t)nxt.pm * tstep : cA; const char* nB = has_next ? (const char*)g.Bt + (size_t)nxt.pn * tstep : cB;
        for (int t = 0; t < nt; t += 2) {
            const bool last = (t == nt - 2);
            const char* a1 = cA + (size_t)(t + 1) * kstep;
            const char* a2 = last ? nA : cA + (size_t)(t + 2) * kstep; const char* b2 = last ? nB : cB + (size_t)(t + 2) * kstep;
            const char* a3 = a2 + kstep; const char* b3 = b2 + kstep;
            PG8_LDB(B0, 0, 0); PG8_SCHED; PG8_LDA(At, 0, 0); PG8_STAGE(PG8_SA(1, 1), a1 + hstep, voffA);
            PG8_WAIT_L(8); PG8_BAR; PG8_WAIT_L(0); PG8_MMA(0, 0, At, B0); PG8_BAR; PG8_SCHED;
            PG8_LDB(B1, 0, 1); PG8_STAGE(PG8_SB(0, 0), b2, voffB);
            PG8_BAR; PG8_WAIT_L(0); PG8_MMA(0, 1, At, B1); PG8_BAR;
            PG8_LDA(At, 0, 1); PG8_STAGE(PG8_SA(0, 0), a2, voffA);
            PG8_BAR; PG8_WAIT_L(0); PG8_MMA(1, 0, At, B0); PG8_BAR; PG8_SCHED;
            PG8_STAGE(PG8_SB(0, 1), b2 + hstep, voffB);
            PG8_WAIT_V(6); PG8_BAR; PG8_MMA(1, 1, At, B1); PG8_BAR;
            PG8_LDB(B0, 1, 0); PG8_SCHED; PG8_LDA(At, 1, 0); PG8_STAGE(PG8_SA(0, 1), a2 + hstep, voffA);
            PG8_WAIT_L(8); PG8_BAR; PG8_WAIT_L(0); PG8_MMA(0, 0, At, B0); PG8_BAR; PG8_SCHED;
            PG8_LDB(B1, 1, 1); PG8_STAGE(PG8_SB(1, 0), b3, voffB);
            PG8_BAR; PG8_WAIT_L(0); PG8_MMA(0, 1, At, B1); PG8_BAR;
            PG8_LDA(At, 1, 1); PG8_STAGE(PG8_SA(1, 0), a3, voffA);
            PG8_BAR; PG8_WAIT_L(0); PG8_MMA(1, 0, At, B0); PG8_BAR; PG8_SCHED;
            PG8_STAGE(PG8_SB(1, 1), b3 + hstep, voffB);
            PG8_WAIT_V(6); PG8_BAR; PG8_MMA(1, 1, At, B1); PG8_BAR;
        }
        E(acc, cur, wr, wc, fr, fq);
        if (!has_next) break;
#pragma unroll
        for (int a = 0; a < 2; ++a)
#pragma unroll
            for (int b = 0; b < 2; ++b)
#pragma unroll
                for (int m = 0; m < 4; ++m)
#pragma unroll
                    for (int n = 0; n < 2; ++n) acc[a][b][m][n] = (f32x4){0.f, 0.f, 0.f, 0.f};
        cur = nxt; cA = nA; cB = nB; ++ui;
    }
    PG8_WAIT_V(0);
    if (wr == 0) PG8_BAR;
    PG8_BAR;
#undef PG8_SA
#undef PG8_SB
#undef PG8_STAGE
#undef PG8_LDA
#undef PG8_LDB
#undef PG8_MMA
#undef PG8_WAIT_V
#undef PG8_WAIT_L
#undef PG8_BAR
#undef PG8_SCHED
}
}
using pg8::Unit;
typedef const f32x4 (&AccRef)[2][2][4][2];

DI u32x4 pack8(f32x4 a, f32x4 b) { u32x4 w; w.x = pk2(a[0], a[1]); w.y = pk2(a[2], a[3]); w.z = pk2(b[0], b[1]); w.w = pk2(b[2], b[3]); return w; }

struct EpiProjA {
    bf16* qka; bf16* qkvb; bf16* zb; const float* rstd;
    DI void operator()(AccRef acc, const Unit& u, int wr, int wc, int fr, int fq) const {
        bf16* base; int ldc, colt; const bool act = u.pn >= 20;
        if (u.pn < 8) { base = qka; ldc = 2048; colt = 256 * u.pn; } else if (u.pn < 20) { base = qkvb; ldc = 3072; colt = 256 * (u.pn - 8); } else { base = zb; ldc = 1024; colt = 256 * (u.pn - 20); }
        const int row0 = u.pm * 256 + wr * 64 + fr, col0 = colt + wc * 32 + 8 * fq;
#pragma unroll
        for (int ai = 0; ai < 2; ++ai)
#pragma unroll
            for (int m = 0; m < 4; ++m) { const int row = row0 + ai * 128 + m * 16; const float rs = rstd[row]; bf16* rowp = base + (size_t)row * ldc + col0;
#pragma unroll
                for (int bj = 0; bj < 2; ++bj) { f32x4 v0 = acc[ai][bj][m][0] * rs, v1 = acc[ai][bj][m][1] * rs;
                    if (act) {
#pragma unroll
                        for (int j = 0; j < 4; ++j) { v0[j] = siluf_(v0[j]); v1[j] = siluf_(v1[j]); } }
                    *(u32x4*)(rowp + bj * 128) = pack8(v0, v1); } }
    }
};
struct EpiProjV {
    bf16* vt; const float* rstd;
    DI void operator()(AccRef acc, const Unit& u, int wr, int wc, int fr, int fq) const {
        const int row0 = u.pm * 256 + wr * 64 + fr, col0 = u.pn * 256 + wc * 32 + 8 * fq;
#pragma unroll
        for (int bj = 0; bj < 2; ++bj) { const int tok = col0 + bj * 128; const f32x4 r0 = *(const f32x4*)(rstd + tok), r1 = *(const f32x4*)(rstd + tok + 4);
            const int b = tok >> 11, s = tok & 2047;
#pragma unroll
            for (int ai = 0; ai < 2; ++ai)
#pragma unroll
                for (int m = 0; m < 4; ++m) { const int ch = row0 + ai * 128 + m * 16; const int hh = ch >> 7, dv = ch & 127;
                    *(u32x4*)(vt + ((size_t)((b * NH + hh) * DH + dv)) * SEQ + s) = pack8(acc[ai][bj][m][0] * r0, acc[ai][bj][m][1] * r1); } }
    }
};
struct EpiGate {
    bf16* g; const float* rstd;
    DI void operator()(AccRef acc, const Unit& u, int wr, int wc, int fr, int fq) const {
        const int row0 = u.pm * 256 + wr * 64 + fr, col0 = u.pn * 256 + wc * 32 + 8 * fq;
#pragma unroll
        for (int ai = 0; ai < 2; ++ai)
#pragma unroll
            for (int m = 0; m < 4; ++m) { const int row = row0 + ai * 128 + m * 16; const float rs = rstd[row]; bf16* rowp = g + (size_t)row * 4096 + col0;
#pragma unroll
                for (int bj = 0; bj < 2; ++bj) { f32x4 v0 = acc[ai][bj][m][0] * rs, v1 = acc[ai][bj][m][1] * rs;
#pragma unroll
                    for (int j = 0; j < 4; ++j) { v0[j] = sigmoidf_(v0[j]); v1[j] = sigmoidf_(v1[j]); }
                    *(u32x4*)(rowp + bj * 128) = pack8(v0, v1); } }
    }
};
template <int SECOND> struct EpiUp {
    const bf16* g; bf16* pp; bf16* merged;
    DI void operator()(AccRef acc, const Unit& u, int wr, int wc, int fr, int fq) const {
        const int row0 = u.pm * 256 + wr * 64 + fr, col0 = u.pn * 256 + wc * 32 + 8 * fq;
#pragma unroll
        for (int ai = 0; ai < 2; ++ai)
#pragma unroll
            for (int m = 0; m < 4; ++m) { const int row = row0 + ai * 128 + m * 16;
#pragma unroll
                for (int bj = 0; bj < 2; ++bj) { const int col = col0 + bj * 128;
                    const u32x4 gw = *(const u32x4*)(g + (size_t)row * 4096 + (SECOND ? 2048 : 0) + col);
                    f32x4 g0 = {bflo(gw.x), bfhi(gw.x), bflo(gw.y), bfhi(gw.y)}, g1 = {bflo(gw.z), bfhi(gw.z), bflo(gw.w), bfhi(gw.w)};
                    f32x4 v0 = acc[ai][bj][m][0] * g0, v1 = acc[ai][bj][m][1] * g1;
                    if (SECOND) { const u32x4 pw = *(const u32x4*)(pp + (size_t)row * 2048 + col);
                        v0 += (f32x4){bflo(pw.x), bfhi(pw.x), bflo(pw.y), bfhi(pw.y)}; v1 += (f32x4){bflo(pw.z), bfhi(pw.z), bflo(pw.w), bfhi(pw.w)};
                        *(u32x4*)(merged + (size_t)row * 2048 + col) = pack8(v0, v1);
                    } else *(u32x4*)(pp + (size_t)row * 2048 + col) = pack8(v0, v1); } }
    }
};
struct EpiOut {
    const float* x; float* out; bf16* y1b; float* sumsq;
    DI void operator()(AccRef acc, const Unit& u, int wr, int wc, int fr, int fq) const {
        const int row0 = u.pm * 256 + wr * 64 + fr, col0 = u.pn * 256 + wc * 32 + 8 * fq;
#pragma unroll
        for (int ai = 0; ai < 2; ++ai)
#pragma unroll
            for (int m = 0; m < 4; ++m) { const int row = row0 + ai * 128 + m * 16; float ss = 0.f;
#pragma unroll
                for (int bj = 0; bj < 2; ++bj) { const size_t off = (size_t)row * 2048 + col0 + bj * 128;
                    const f32x4 x0 = *(const f32x4*)(x + off), x1 = *(const f32x4*)(x + off + 4);
                    const f32x4 v0 = acc[ai][bj][m][0] + x0, v1 = acc[ai][bj][m][1] + x1;
                    *(f32x4*)(out + off) = v0; *(f32x4*)(out + off + 4) = v1;
                    *(u32x4*)(y1b + off) = pack8(v0, v1);
                    ss += (v0[0] * v0[0] + v0[1] * v0[1]) + (v0[2] * v0[2] + v0[3] * v0[3]) + (v1[0] * v1[0] + v1[1] * v1[1]) + (v1[2] * v1[2] + v1[3] * v1[3]); }
                ss += __shfl_xor(ss, 16); ss += __shfl_xor(ss, 32);
                if (fq == 0) atomicAdd(sumsq + row, ss); }
    }
};
struct EpiQry {
    bf16* qry; const float* sumsq;
    DI void operator()(AccRef acc, const Unit& u, int wr, int wc, int fr, int fq) const {
        const int row0 = u.pm * 256 + wr * 64 + fr, col0 = u.pn * 256 + wc * 32 + 8 * fq;
#pragma unroll
        for (int ai = 0; ai < 2; ++ai)
#pragma unroll
            for (int m = 0; m < 4; ++m) { const int row = row0 + ai * 128 + m * 16; const float rs = rsqrtf(sumsq[row] * (1.f / D) + EPS);
#pragma unroll
                for (int bj = 0; bj < 2; ++bj) *(u32x4*)(qry + (size_t)row * 2048 + col0 + bj * 128) = pack8(acc[ai][bj][m][0] * rs, acc[ai][bj][m][1] * rs); }
    }
};

struct Args { const float* in[18]; float* out; unsigned char* ws; int ph_lo, ph_hi; };
enum { I_X = 0, I_RELB, I_N1G, I_WIN, I_CONVW, I_ALOG, I_DTB, I_QNG, I_KNG, I_GDNG, I_WUPA, I_WUPB, I_WOUT, I_N2G, I_WQ, I_SK, I_PU, I_PV };

DI void p0_transpose_item(const float* W, int N, int srccol0, int K, const float* gain, bf16* WT, int drow0, LAS float* scr, int item, int nblk, int lane) {
    const int kb = item / nblk, nb = item % nblk, k0 = 64 * kb, n0 = 32 * nb;
#pragma unroll 8
    for (int i = 0; i < 32; ++i) { const int kk = 2 * i + (lane >> 5); const float gg = gain ? gain[k0 + kk] : 1.f; scr[kk * 33 + (lane & 31)] = W[(size_t)(k0 + kk) * N + srccol0 + n0 + (lane & 31)] * gg; }
    LDS_WAIT(); asm volatile("" ::: "memory");
    const int c = lane & 7;
#pragma unroll
    for (int j = 0; j < 4; ++j) { const int n = (lane >> 3) + 8 * j; const LAS float* s = scr + (8 * c) * 33 + n;
        u32x4 o; o.x = pk2(s[0 * 33], s[1 * 33]); o.y = pk2(s[2 * 33], s[3 * 33]); o.z = pk2(s[4 * 33], s[5 * 33]); o.w = pk2(s[6 * 33], s[7 * 33]);
        *(u32x4*)(WT + (size_t)(drow0 + n0 + n) * K + k0 + 8 * c) = o; }
    LDS_WAIT(); asm volatile("" ::: "memory");
}
__constant__ const int kBucketThr[16] = {16, 19, 21, 24, 27, 31, 35, 40, 46, 52, 59, 67, 77, 87, 99, 113};
DI void phase0(const Args& a, LAS unsigned char* lds, int vcu, int G) {
    const int tid = threadIdx.x, lane = tid & 63, wave = tid >> 6;
    const int gw = vcu * 8 + wave, NGW = G * 8;
    unsigned char* ws = a.ws;
    LAS float* scr = (LAS float*)(lds + wave * 16384);
    const float* g1 = a.in[I_N1G]; const float* g2 = a.in[I_N2G];
    constexpr int NSEG = 10;
    const float* sW[NSEG] = {a.in[I_WIN], a.in[I_WIN], a.in[I_WIN], a.in[I_WIN], a.in[I_WIN], a.in[I_WIN], a.in[I_WUPA], a.in[I_WUPB], a.in[I_WOUT], a.in[I_WQ]};
    const int sN[NSEG] = {IN_TOTAL, IN_TOTAL, IN_TOTAL, IN_TOTAL, IN_TOTAL, IN_TOTAL, 2048, 2048, 2048, 2048};
    const int sC0[NSEG] = {0, 3072, 6144, 2048, 7184, 9232, 0, 0, 0, 0};
    const int sK[NSEG] = {2048, 2048, 2048, 2048, 2048, 2048, 1024, 1024, 2048, 2048};
    const float* sG[NSEG] = {g1, g1, g1, g1, g1, g1, nullptr, nullptr, nullptr, g2};
    bf16* sD[NSEG] = {(bf16*)(ws + WS_WINA), (bf16*)(ws + WS_WINA), (bf16*)(ws + WS_WINA), (bf16*)(ws + WS_WINA), (bf16*)(ws + WS_WINB), (bf16*)(ws + WS_WINB),
                      (bf16*)(ws + WS_WUPA), (bf16*)(ws + WS_WUPB), (bf16*)(ws + WS_WOUT), (bf16*)(ws + WS_WQ)};
    const int sR0[NSEG] = {0, 2048, 5120, 6144, 0, 2048, 0, 0, 0, 0};
    const int sNR[NSEG] = {2048, 3072, 1024, 1024, 2048, 2048, 2048, 2048, 2048, 2048};
    int base = 0;
#pragma unroll
    for (int sidx = 0; sidx < NSEG; ++sidx) {
        const int nblk = sNR[sidx] / 32, nit = nblk * (sK[sidx] / 64);
        int first = ((gw - base) % NGW + NGW) % NGW;
        for (int j = first; j < nit; j += NGW) p0_transpose_item(sW[sidx], sN[sidx], sC0[sidx], sK[sidx], sG[sidx], sD[sidx], sR0[sidx], scr, j, nblk, lane);
        base += nit;
    }
    const size_t gtid = (size_t)vcu * 512 + tid, gsz = (size_t)G * 512;
    { bf16* wbat = (bf16*)(ws + WS_WBAT); for (size_t i = gtid; i < 16 * 2048; i += gsz) { const int c = (int)(i >> 11), k = (int)(i & 2047); wbat[i] = f2bf(a.in[I_WIN][(size_t)k * IN_TOTAL + 7168 + c] * g1[k]); } }
    { bf16* sk = (bf16*)(ws + WS_SK); const float* s = a.in[I_SK]; for (size_t i = gtid; i < 262144 / 4; i += gsz) { const f32x4 v = ((const f32x4*)s)[i]; u32x2 o; o.x = pk2(v[0], v[1]); o.y = pk2(v[2], v[3]); ((u32x2*)sk)[i] = o; } }
    { float* bt = (float*)(ws + WS_BIAS); for (size_t i = gtid; i < 8 * 128; i += gsz) { const int hh = (int)(i >> 7), n = (int)(i & 127); int bk = n;
        if (n >= 16) { bk = 15; for (int q = 0; q < 16; ++q) bk += (n >= kBucketThr[q]) ? 1 : 0; }
        bt[i] = a.in[I_RELB][bk * 8 + hh] * LOG2E; } }
    { float* sq = (float*)(ws + WS_SUMSQ2); for (size_t i = gtid; i < T; i += gsz) sq[i] = 0.f; }
    { const float* x = a.in[I_X]; bf16* xb = (bf16*)(ws + WS_XB); float* rstd = (float*)(ws + WS_RSTD1);
      for (int m = gw; m < T; m += NGW) { const f32x4* xr = (const f32x4*)(x + (size_t)m * D) + lane; f32x4 v[8]; float s = 0.f;
#pragma unroll
          for (int j = 0; j < 8; ++j) { v[j] = xr[64 * j]; s += (v[j][0] * v[j][0] + v[j][1] * v[j][1]) + (v[j][2] * v[j][2] + v[j][3] * v[j][3]); }
          s = wave_sum(s); if (lane == 0) rstd[m] = rsqrtf(s * (1.f / D) + EPS);
          u32x2* o8 = (u32x2*)(xb + (size_t)m * D) + lane;
#pragma unroll
          for (int j = 0; j < 8; ++j) { u32x2 o; o.x = pk2(v[j][0], v[j][1]); o.y = pk2(v[j][2], v[j][3]); o8[64 * j] = o; } } }
}

DI void phase_ba(const Args& a, int vcu, int G) {
    const int tid = threadIdx.x, lane = tid & 63, wave = tid >> 6, gw = vcu * 8 + wave, NGW = G * 8;
    unsigned char* ws = a.ws; const bf16* xb = (const bf16*)(ws + WS_XB); const bf16* wbat = (const bf16*)(ws + WS_WBAT); const float* rstd = (const float*)(ws + WS_RSTD1); float* ba = (float*)(ws + WS_BA);
    const int r = lane & 15, q = lane >> 4;
    for (int tile = gw; tile < T / 16; tile += NGW) {
        const bf16* ap = xb + (size_t)(tile * 16 + r) * D + 8 * q; const bf16* bp = wbat + (size_t)r * D + 8 * q;
        f32x4 acc = {0.f, 0.f, 0.f, 0.f};
#pragma unroll 8
        for (int ks = 0; ks < 64; ++ks) { const bf16x8 af = *(const bf16x8*)(ap + 32 * ks), bfr = *(const bf16x8*)(bp + 32 * ks); acc = __builtin_amdgcn_mfma_f32_16x16x32_bf16(af, bfr, acc, 0, 0, 0); }
        const int c = r; const int hh = c & 7;
        const float al = -__expf(a.in[I_ALOG][hh]), dtb = a.in[I_DTB][hh];
#pragma unroll
        for (int j = 0; j < 4; ++j) { const int tok = tile * 16 + 4 * q + j; const float v = acc[j] * rstd[tok]; float o;
            if (c < 8) o = sigmoidf_(v); else { const float z = v + dtb; const float sp = (z > 20.f) ? z : log1pf(__expf(z)); o = al * sp; }
            ba[(size_t)tok * 16 + c] = o; }
    }
}

DI void phase_tables(const Args& a, int vcu, int G) {
    const size_t gtid = (size_t)vcu * 512 + threadIdx.x, gsz = (size_t)G * 512; unsigned char* ws = a.ws;
    const f32x4* pu = (const f32x4*)a.in[I_PU]; const f32x4* pv = (const f32x4*)a.in[I_PV]; const f32x4* g2 = (const f32x4*)a.in[I_N2G];
    u32x2* ub = (u32x2*)(ws + WS_UB); u32x2* vb = (u32x2*)(ws + WS_VB);
    const size_t n4 = (size_t)16384 * 2048 / 4;
    for (size_t i = gtid; i < n4; i += gsz) { const f32x4 u = pu[i] * g2[i & 511]; const f32x4 v = pv[i]; u32x2 o; o.x = pk2(u[0], u[1]); o.y = pk2(u[2], u[3]); ub[i] = o; o.x = pk2(v[0], v[1]); o.y = pk2(v[2], v[3]); vb[i] = o; }
}


DI void moba_prep_unit(const Args& a, LAS unsigned char* lds, int unit) {
    const int tid = threadIdx.x, lane = tid & 63, wave = tid >> 6; unsigned char* ws = a.ws;
    const int b = unit >> 3, blk = unit & 7; const int t0 = b * SEQ + blk * 256 + wave * 32;
    bf16* qka = (bf16*)(ws + WS_QKA); float* kmean = (float*)(ws + WS_KMEAN);
    const float* qg = a.in[I_QNG]; const float* kg = a.in[I_KNG];
    float gq[8], gk[8];
#pragma unroll
    for (int e = 0; e < 8; ++e) { gq[e] = qg[8 * (lane & 15) + e] * (0.08838834764831845f * LOG2E); gk[e] = kg[8 * (lane & 15) + e]; }
    float ks[2][8];
#pragma unroll
    for (int j = 0; j < 2; ++j)
#pragma unroll
        for (int e = 0; e < 8; ++e) ks[j][e] = 0.f;
    for (int i = 0; i < 32; ++i) {
        u32x4* row = (u32x4*)(qka + (size_t)(t0 + i) * 2048) + lane;
#pragma unroll
        for (int j = 0; j < 4; ++j) { const u32x4 w = row[64 * j]; float v[8] = {bflo(w.x), bfhi(w.x), bflo(w.y), bfhi(w.y), bflo(w.z), bfhi(w.z), bflo(w.w), bfhi(w.w)};
            float ss = 0.f;
#pragma unroll
            for (int e = 0; e < 8; ++e) ss += v[e] * v[e];
            ss += __shfl_xor(ss, 1); ss += __shfl_xor(ss, 2); ss += __shfl_xor(ss, 4); ss += __shfl_xor(ss, 8);
            const float rn = rsqrtf(ss * (1.f / 128.f) + EPS);
#pragma unroll
            for (int e = 0; e < 8; ++e) { v[e] = v[e] * rn * (j < 2 ? gq[e] : gk[e]); if (j >= 2) ks[j - 2][e] += v[e]; }
            u32x4 o; o.x = pk2(v[0], v[1]); o.y = pk2(v[2], v[3]); o.z = pk2(v[4], v[5]); o.w = pk2(v[6], v[7]); row[64 * j] = o; }
    }
    LAS float* red = (LAS float*)lds;
#pragma unroll
    for (int j = 0; j < 2; ++j)
#pragma unroll
        for (int e = 0; e < 8; ++e) red[wave * 1024 + 512 * j + 8 * lane + e] = ks[j][e];
    __syncthreads();
    for (int c = tid; c < 1024; c += 512) { float s = 0.f;
#pragma unroll
        for (int w = 0; w < 8; ++w) s += red[w * 1024 + c];
        kmean[((size_t)((b * NH + (c >> 7)) * 8 + blk)) * 128 + (c & 127)] = s * (1.f / 256.f); }
    __syncthreads();
}

DI bf16x8 frag_b128(const LAS unsigned char* base, int pitch, int row, int k0, int lane) { return *(const LAS bf16x8*)(base + (row + (lane & 15)) * pitch + (k0 + 8 * (lane >> 4)) * 2); }
DI bf16x8 frag_b64x2(const LAS unsigned char* base, int pitch, int row, int k0, int lane) {
    const LAS bf16x4* p = (const LAS bf16x4*)(base + (row + (lane & 15)) * pitch + (k0 + 8 * (lane >> 4)) * 2); const bf16x4 lo = p[0], hi = p[1];
    return __builtin_shufflevector(lo, hi, 0, 1, 2, 3, 4, 5, 6, 7); }
#define MFMA16(a, b, c) __builtin_amdgcn_mfma_f32_16x16x32_bf16((a), (b), (c), 0, 0, 0)
#define MFMA32(a, b, c) __builtin_amdgcn_mfma_f32_32x32x16_bf16((a), (b), (c), 0, 0, 0)

namespace gp {
constexpr int P_ROW = 272, P_T = 136, P_TM = 144;
constexpr int O_QN = 0, O_KN = 17408, O_KBGT = 34816, O_KDT = 52224, O_VBT = 69632, O_LT = 87040, O_TM = 103424, O_ATT = 112640, O_SC = 120832;
}
DI void gdn_prep_unit(const Args& a, LAS unsigned char* lds, int unit) {
    using namespace gp;
    const int tid = threadIdx.x, lane = tid & 63, wave = __builtin_amdgcn_readfirstlane(tid >> 6); unsigned char* ws = a.ws;
    const int n = unit & 31, h = (unit >> 5) & 7, b = unit >> 8;
    const int t0 = b * SEQ + n * 64;
    const float* ba = (const float*)(ws + WS_BA); const bf16* qkvb = (const bf16*)(ws + WS_QKVB); const float* cw = a.in[I_CONVW];
    bf16* gW = (bf16*)(ws + WS_GW) + (size_t)unit * 8192; bf16* gQD = (bf16*)(ws + WS_GQD) + (size_t)unit * 8192; bf16* gKDT = (bf16*)(ws + WS_GKDT) + (size_t)unit * 8192;
    bf16* gUT = (bf16*)(ws + WS_GUT) + (size_t)unit * 8192; bf16* gATT = (bf16*)(ws + WS_GATT) + (size_t)unit * 4096;
    LAS float* SC = (LAS float*)(lds + O_SC);
    if (wave == 0) {
        const float be = ba[(size_t)(t0 + lane) * 16 + h], g = ba[(size_t)(t0 + lane) * 16 + 8 + h];
        float c = g;
#pragma unroll
        for (int o = 1; o < 64; o <<= 1) { const float v = __shfl_up(c, o); if (lane >= o) c += v; }
        SC[lane] = be; SC[64 + lane] = c; SC[128 + lane] = __expf(c);
        if (lane == 63) ((float*)(ws + WS_EGL))[unit] = __expf(c);
    }
    __syncthreads();
    const float glast = SC[64 + 63];
    for (int i = 0; i < 6; ++i) {
        const int p = tid + 512 * i, tt = p / 48, c48 = p % 48, part = c48 >> 4, cc = c48 & 15;
        const int col = part * 1024 + h * 128 + 8 * cc; const int s = n * 64 + tt;
        float o[8];
#pragma unroll
        for (int e = 0; e < 8; ++e) o[e] = 0.f;
#pragma unroll
        for (int tap = 0; tap < 4; ++tap) { const int sp = s - 3 + tap;
            if (sp >= 0) { const u32x4 w = *(const u32x4*)(qkvb + (size_t)(b * SEQ + sp) * 3072 + col);
                const f32x4 c0 = *(const f32x4*)(cw + tap * 3072 + col), c1 = *(const f32x4*)(cw + tap * 3072 + col + 4);
                o[0] += bflo(w.x) * c0[0]; o[1] += bfhi(w.x) * c0[1]; o[2] += bflo(w.y) * c0[2]; o[3] += bfhi(w.y) * c0[3];
                o[4] += bflo(w.z) * c1[0]; o[5] += bfhi(w.z) * c1[1]; o[6] += bflo(w.w) * c1[2]; o[7] += bfhi(w.w) * c1[3]; } }
        float ss = 0.f;
#pragma unroll
        for (int e = 0; e < 8; ++e) { o[e] = siluf_(o[e]); ss += o[e] * o[e]; }
        ss += __shfl_xor(ss, 1); ss += __shfl_xor(ss, 2); ss += __shfl_xor(ss, 4); ss += __shfl_xor(ss, 8);
        const float rn = rsqrtf(ss + EPS);
        const float be = SC[tt], gcv = SC[64 + tt], egv = SC[128 + tt];
        if (part == 0) {
            const float sc = rn * 0.08838834764831845f;
#pragma unroll
            for (int e = 0; e < 8; ++e) o[e] *= sc;
            u32x4 w; w.x = pk2(o[0], o[1]); w.y = pk2(o[2], o[3]); w.z = pk2(o[4], o[5]); w.w = pk2(o[6], o[7]);
            *(LAS u32x4*)(lds + O_QN + tt * P_ROW + cc * 16) = w;
            u32x4 d; d.x = pk2(o[0] * egv, o[1] * egv); d.y = pk2(o[2] * egv, o[3] * egv); d.z = pk2(o[4] * egv, o[5] * egv); d.w = pk2(o[6] * egv, o[7] * egv);
            *(u32x4*)(gQD + tt * 128 + cc * 8) = d;
        } else if (part == 1) {
#pragma unroll
            for (int e = 0; e < 8; ++e) o[e] *= rn;
            u32x4 w; w.x = pk2(o[0], o[1]); w.y = pk2(o[2], o[3]); w.z = pk2(o[4], o[5]); w.w = pk2(o[6], o[7]);
            *(LAS u32x4*)(lds + O_KN + tt * P_ROW + cc * 16) = w;
            const float f1 = be * egv, f2 = __expf(glast - gcv);
#pragma unroll
            for (int e = 0; e < 8; ++e) { *(LAS bf16*)(lds + O_KBGT + (8 * cc + e) * P_T + tt * 2) = f2bf(o[e] * f1); *(LAS bf16*)(lds + O_KDT + (8 * cc + e) * P_T + tt * 2) = f2bf(o[e] * f2); }
        } else {
#pragma unroll
            for (int e = 0; e < 8; ++e) *(LAS bf16*)(lds + O_VBT + (8 * cc + e) * P_T + tt * 2) = f2bf(o[e] * be);
        }
    }
    __syncthreads();
    {
        const int mi = wave >> 1, ni0 = 2 * (wave & 1);
        f32x4 kk[2] = {{0.f, 0.f, 0.f, 0.f}, {0.f, 0.f, 0.f, 0.f}}, qk[2] = {{0.f, 0.f, 0.f, 0.f}, {0.f, 0.f, 0.f, 0.f}};
#pragma unroll
        for (int ks = 0; ks < 4; ++ks) {
            const bf16x8 ak = frag_b128(lds + O_KN, P_ROW, 16 * mi, 32 * ks, lane), aq = frag_b128(lds + O_QN, P_ROW, 16 * mi, 32 * ks, lane);
#pragma unroll
            for (int t = 0; t < 2; ++t) { const bf16x8 bk = frag_b128(lds + O_KN, P_ROW, 16 * (ni0 + t), 32 * ks, lane); kk[t] = MFMA16(ak, bk, kk[t]); qk[t] = MFMA16(aq, bk, qk[t]); }
        }
        const int nn = lane & 15, q = lane >> 4;
        LAS float* LT = (LAS float*)(lds + O_LT);
#pragma unroll
        for (int t = 0; t < 2; ++t) { const int jj = 16 * (ni0 + t) + nn; const float gj = SC[64 + jj];
#pragma unroll
            for (int j = 0; j < 4; ++j) { const int i = 16 * mi + 4 * q + j; const float dec = (i >= jj) ? __expf(SC[64 + i] - gj) : 0.f;
                LT[jj * 64 + i] = (i > jj) ? SC[i] * kk[t][j] * dec : 0.f;
                *(LAS bf16*)(lds + O_ATT + (i * 64 + jj) * 2) = f2bf(qk[t][j] * dec); } }
    }
    __syncthreads();
    if (wave == 0) {
        const LAS float* LT = (const LAS float*)(lds + O_LT); int ln = lane;
        asm volatile("" : "+v"(LT), "+v"(ln));
        float t[64];
#pragma unroll
        for (int j = 63; j >= 0; --j) { float s = (ln == j) ? 1.f : 0.f;
#pragma unroll
            for (int i = j + 1; i < 64; ++i) s -= t[i] * LT[j * 64 + i];
            t[j] = s; asm volatile("" : "+v"(t[j]) :: "memory"); }
#pragma unroll
        for (int c = 0; c < 8; ++c) { u32x4 w; w.x = pk2(t[8 * c], t[8 * c + 1]); w.y = pk2(t[8 * c + 2], t[8 * c + 3]); w.z = pk2(t[8 * c + 4], t[8 * c + 5]); w.w = pk2(t[8 * c + 6], t[8 * c + 7]);
            *(LAS u32x4*)(lds + O_TM + lane * P_TM + c * 16) = w; }
    } else {
        const int t2 = tid - 64;
        for (int c = t2; c < 512; c += 448) *(u32x4*)((unsigned char*)gATT + c * 16) = *(const LAS u32x4*)(lds + O_ATT + c * 16);
        for (int c = t2; c < 1024; c += 448) { const int row = c >> 3, cc = c & 7; const LAS u32x2* p = (const LAS u32x2*)(lds + O_KDT + row * P_T + cc * 16); const u32x2 lo = p[0], hi = p[1];
            u32x4 w; w.x = lo.x; w.y = lo.y; w.z = hi.x; w.w = hi.y; *(u32x4*)((unsigned char*)gKDT + c * 16) = w; }
    }
    __syncthreads();
    {
        const int nn = lane & 15, q = lane >> 4;
        bf16x8 vb[2], kb[2];
#pragma unroll
        for (int ks = 0; ks < 2; ++ks) { vb[ks] = frag_b64x2(lds + O_VBT, P_T, 16 * wave, 32 * ks, lane); kb[ks] = frag_b64x2(lds + O_KBGT, P_T, 16 * wave, 32 * ks, lane); }
#pragma unroll
        for (int mi = 0; mi < 4; ++mi) {
            f32x4 u = {0.f, 0.f, 0.f, 0.f}, wt = {0.f, 0.f, 0.f, 0.f};
#pragma unroll
            for (int ks = 0; ks < 2; ++ks) { const bf16x8 tf = frag_b128(lds + O_TM, P_TM, 16 * mi, 32 * ks, lane); u = MFMA16(tf, vb[ks], u); wt = MFMA16(kb[ks], tf, wt); }
            u32x2 o; o.x = pk2(u[0], u[1]); o.y = pk2(u[2], u[3]); *(u32x2*)(gUT + (16 * wave + nn) * 64 + 16 * mi + 4 * q) = o;
            o.x = pk2(wt[0], wt[1]); o.y = pk2(wt[2], wt[3]); *(u32x2*)(gW + (16 * mi + nn) * 128 + 16 * wave + 4 * q) = o;
        }
    }
    __syncthreads();
}


namespace gs {
constexpr int P_ROW = 272, P_T = 136, P_ATT = 144;
constexpr int O_W = 0, O_QD = 17408, O_ATT = 34816, O_KDT = 44032, O_ST = 61440, O_VNT = 96256, O_SSQ = 113664;
}
DI void gdn_scan_unit(const Args& a, LAS unsigned char* lds, int bh) {
    using namespace gs;
    const int tid = threadIdx.x, lane = tid & 63, wave = __builtin_amdgcn_readfirstlane(tid >> 6); unsigned char* ws = a.ws;
    const int b = bh >> 3, h = bh & 7; const int nn = lane & 15, q = lane >> 4;
    const float* egl = (const float*)(ws + WS_EGL) + bh * 32;
    const bf16* zb = (const bf16*)(ws + WS_ZB); bf16* ob = (bf16*)(ws + WS_OB);
    const float gain = a.in[I_GDNG][16 * wave + nn];
    f32x4 S[8];
#pragma unroll
    for (int mt = 0; mt < 8; ++mt) S[mt] = (f32x4){0.f, 0.f, 0.f, 0.f};
    for (int c = lane; c < 16 * 17; c += 64) *(LAS u32x4*)(lds + O_ST + (16 * wave) * P_ROW + c * 16) = (u32x4){0u, 0u, 0u, 0u};
    u32x4 pf[7];
    auto issue = [&](int unit) {
        const unsigned char* pW = (const unsigned char*)(ws + WS_GW) + (size_t)unit * 16384; const unsigned char* pQ = (const unsigned char*)(ws + WS_GQD) + (size_t)unit * 16384;
        const unsigned char* pA = (const unsigned char*)(ws + WS_GATT) + (size_t)unit * 8192; const unsigned char* pK = (const unsigned char*)(ws + WS_GKDT) + (size_t)unit * 16384;
        pf[0] = *(const u32x4*)(pW + tid * 16); pf[1] = *(const u32x4*)(pW + (tid + 512) * 16);
        pf[2] = *(const u32x4*)(pQ + tid * 16); pf[3] = *(const u32x4*)(pQ + (tid + 512) * 16);
        pf[4] = *(const u32x4*)(pA + tid * 16);
        pf[5] = *(const u32x4*)(pK + tid * 16); pf[6] = *(const u32x4*)(pK + (tid + 512) * 16);
    };
    auto commit = [&]() {
#pragma unroll
        for (int i = 0; i < 2; ++i) { const int c = tid + 512 * i; *(LAS u32x4*)(lds + O_W + (c >> 4) * P_ROW + (c & 15) * 16) = pf[i]; *(LAS u32x4*)(lds + O_QD + (c >> 4) * P_ROW + (c & 15) * 16) = pf[2 + i];
            LAS u32x2* kp = (LAS u32x2*)(lds + O_KDT + (c >> 3) * P_T + (c & 7) * 16); kp[0] = (u32x2){pf[5 + i].x, pf[5 + i].y}; kp[1] = (u32x2){pf[5 + i].z, pf[5 + i].w}; }
        *(LAS u32x4*)(lds + O_ATT + (tid >> 3) * P_ATT + (tid & 7) * 16) = pf[4];
    };
    issue(bh * 32);
    for (int n = 0; n < 32; ++n) {
        const int unit = bh * 32 + n;
        commit();
        __syncthreads();
        if (n + 1 < 32) issue(unit + 1);
        const float eg = egl[n];
        const bf16* gUT = (const bf16*)(ws + WS_GUT) + (size_t)unit * 8192;
        u32x2 uw[4];
#pragma unroll
        for (int mi = 0; mi < 4; ++mi) uw[mi] = *(const u32x2*)(gUT + (16 * wave + nn) * 64 + 16 * mi + 4 * q);
        bf16x8 sf[4];
#pragma unroll
        for (int ks = 0; ks < 4; ++ks) sf[ks] = frag_b128(lds + O_ST, P_ROW, 16 * wave, 32 * ks, lane);
#pragma unroll
        for (int mi = 0; mi < 4; ++mi) { f32x4 acc = {0.f, 0.f, 0.f, 0.f};
#pragma unroll
            for (int ks = 0; ks < 4; ++ks) acc = MFMA16(frag_b128(lds + O_W, P_ROW, 16 * mi, 32 * ks, lane), sf[ks], acc);
            const float v0 = bflo(uw[mi].x) - acc[0], v1 = bfhi(uw[mi].x) - acc[1], v2 = bflo(uw[mi].y) - acc[2], v3 = bfhi(uw[mi].y) - acc[3];
            u32x2 o; o.x = pk2(v0, v1); o.y = pk2(v2, v3); *(LAS u32x2*)(lds + O_VNT + (16 * wave + nn) * P_T + (16 * mi + 4 * q) * 2) = o; }
        bf16x8 vf[2];
#pragma unroll
        for (int ks = 0; ks < 2; ++ks) vf[ks] = frag_b64x2(lds + O_VNT, P_T, 16 * wave, 32 * ks, lane);
        f32x4 o4[4];
#pragma unroll
        for (int mi = 0; mi < 4; ++mi) { f32x4 acc = {0.f, 0.f, 0.f, 0.f};
#pragma unroll
            for (int ks = 0; ks < 4; ++ks) acc = MFMA16(frag_b128(lds + O_QD, P_ROW, 16 * mi, 32 * ks, lane), sf[ks], acc);
#pragma unroll
            for (int ks = 0; ks < 2; ++ks) acc = MFMA16(frag_b128(lds + O_ATT, P_ATT, 16 * mi, 32 * ks, lane), vf[ks], acc);
            o4[mi] = acc; }
#pragma unroll
        for (int mt = 0; mt < 8; ++mt) { f32x4 acc = S[mt] * eg;
#pragma unroll
            for (int ks = 0; ks < 2; ++ks) acc = MFMA16(frag_b64x2(lds + O_KDT, P_T, 16 * mt, 32 * ks, lane), vf[ks], acc);
            S[mt] = acc;
            u32x2 o; o.x = pk2(acc[0], acc[1]); o.y = pk2(acc[2], acc[3]); *(LAS u32x2*)(lds + O_ST + (16 * wave + nn) * P_ROW + (16 * mt + 4 * q) * 2) = o; }
        LAS float* SSQ = (LAS float*)(lds + O_SSQ);
#pragma unroll
        for (int mi = 0; mi < 4; ++mi) {
#pragma unroll
            for (int j = 0; j < 4; ++j) { float ss = o4[mi][j] * o4[mi][j]; ss += __shfl_xor(ss, 1); ss += __shfl_xor(ss, 2); ss += __shfl_xor(ss, 4); ss += __shfl_xor(ss, 8);
                if (nn == 0) SSQ[wave * 64 + 16 * mi + 4 * q + j] = ss; } }
        __syncthreads();
#pragma unroll
        for (int mi = 0; mi < 4; ++mi) {
#pragma unroll
            for (int j = 0; j < 4; ++j) { const int tok = 16 * mi + 4 * q + j; float ss = 0.f;
#pragma unroll
                for (int w = 0; w < 8; ++w) ss += SSQ[w * 64 + tok];
                const float rn = rsqrtf(ss * (1.f / 128.f) + EPS);
                const size_t off = (size_t)(b * SEQ + n * 64 + tok) * 1024 + h * 128 + 16 * wave + nn;
                ob[off] = f2bf(o4[mi][j] * rn * gain * bf2f(zb[off])); } }
    }
    __syncthreads();
}

namespace ma {
constexpr int P_K = 272, P_V = 136;
constexpr int O_K0 = 0, O_V0 = 17408, O_K1 = 34816, O_V1 = 52224, O_KM = 69632, O_BIAS = 73728, O_Q = 74752;
}
DI void moba_attn_unit(const Args& a, LAS unsigned char* lds, int unit) {
    using namespace ma;
    const int tid = threadIdx.x, lane = tid & 63, wave = __builtin_amdgcn_readfirstlane(tid >> 6); unsigned char* ws = a.ws;
    const int qb = 7 - (unit >> 6), bh = unit & 63, b = bh >> 3, h = bh & 7;
    const int n = lane & 31, hh = lane >> 5;
    const bf16* qka = (const bf16*)(ws + WS_QKA); const bf16* vt = (const bf16*)(ws + WS_VT) + (size_t)bh * DH * SEQ; bf16* oa = (bf16*)(ws + WS_OA);
    const int tokb = b * SEQ;
    { const float* km = (const float*)(ws + WS_KMEAN) + (size_t)bh * 8 * 128; LAS float* KM = (LAS float*)(lds + O_KM); for (int i = tid; i < qb * 128; i += 512) KM[i] = km[i];
      const float* bt = (const float*)(ws + WS_BIAS) + h * 128; LAS float* BL = (LAS float*)(lds + O_BIAS); if (tid < 128) BL[tid] = bt[tid]; }
    bf16x8 qf[8];
    { const bf16* qp = qka + (size_t)(tokb + 256 * qb + 32 * wave + n) * 2048 + h * 128 + 8 * hh;
#pragma unroll
      for (int ks = 0; ks < 8; ++ks) qf[ks] = *(const bf16x8*)(qp + 16 * ks); }
    u32x4 pk_[2], pv_[2];
    auto issue = [&](int ti) {
        const int blk = (ti < 4) ? qb : ((ti - 4) >> 2), kt = (ti < 4) ? ti : ((ti - 4) & 3); const int kb = 256 * blk + 64 * kt;
#pragma unroll
        for (int i = 0; i < 2; ++i) { const int c = tid + 512 * i;
            pk_[i] = *(const u32x4*)(qka + (size_t)(tokb + kb + (c >> 4)) * 2048 + 1024 + h * 128 + (c & 15) * 8);
            pv_[i] = *(const u32x4*)(vt + (size_t)(c >> 3) * SEQ + kb + (c & 7) * 8); }
    };
    auto commit = [&](int buf) {
        LAS unsigned char* kl = lds + (buf ? O_K1 : O_K0); LAS unsigned char* vl = lds + (buf ? O_V1 : O_V0);
#pragma unroll
        for (int i = 0; i < 2; ++i) { const int c = tid + 512 * i; *(LAS u32x4*)(kl + (c >> 4) * P_K + (c & 15) * 16) = pk_[i];
            LAS u32x2* vp = (LAS u32x2*)(vl + (c >> 3) * P_V + (c & 7) * 16); vp[0] = (u32x2){pv_[i].x, pv_[i].y}; vp[1] = (u32x2){pv_[i].z, pv_[i].w}; }
    };
    const int ntiles = 4 + 4 * qb;
    issue(0);
    __syncthreads();
    unsigned selmask = 0;
    if (qb > 0) {
        float gsc[7];
        const LAS float* KM = (const LAS float*)(lds + O_KM);
#pragma unroll
        for (int j = 0; j < 7; ++j) { float s = 0.f;
            if (j < qb) {
#pragma unroll
                for (int ks = 0; ks < 8; ++ks) { const u32x4 w = __builtin_bit_cast(u32x4, qf[ks]); const LAS float* kp = KM + j * 128 + 16 * ks + 8 * hh;
                    const f32x4 k0 = *(const LAS f32x4*)kp, k1 = *(const LAS f32x4*)(kp + 4);
                    s += bflo(w.x) * k0[0] + bfhi(w.x) * k0[1] + bflo(w.y) * k0[2] + bfhi(w.y) * k0[3] + bflo(w.z) * k1[0] + bfhi(w.z) * k1[1] + bflo(w.w) * k1[2] + bfhi(w.w) * k1[3]; }
                s += __shfl_xor(s, 32);
            } else s = -__builtin_inff();
            gsc[j] = s; }
        if (qb <= 3) selmask = (1u << qb) - 1u;
        else {
#pragma unroll
            for (int r = 0; r < 3; ++r) { float best = -__builtin_inff(); int bi = 0;
#pragma unroll
                for (int j = 0; j < 7; ++j) { const bool take = (gsc[j] > best); best = take ? gsc[j] : best; bi = take ? j : bi; }
                selmask |= 1u << bi;
#pragma unroll
                for (int j = 0; j < 7; ++j) gsc[j] = (j == bi) ? -__builtin_inff() : gsc[j]; }
        }
    }
    f32x16 oT[4];
#pragma unroll
    for (int mt = 0; mt < 4; ++mt)
#pragma unroll
        for (int i = 0; i < 16; ++i) oT[mt][i] = 0.f;
    float mrow = -__builtin_inff(), lrow = 0.f;
    const LAS float* BL = (const LAS float*)(lds + O_BIAS);
    const float c31 = BL[127];
    commit(0);
    __syncthreads();
    for (int ti = 0; ti < ntiles; ++ti) {
        if (ti + 1 < ntiles) issue(ti + 1);
        const int own = (ti < 4); const int blk = own ? qb : ((ti - 4) >> 2), kt = own ? ti : ((ti - 4) & 3);
        const bool active = own ? (kt <= (wave >> 1)) : true;
        if (active) {
            const LAS unsigned char* kl = lds + ((ti & 1) ? O_K1 : O_K0); const LAS unsigned char* vl = lds + ((ti & 1) ? O_V1 : O_V0);
            f32x16 sT[2];
#pragma unroll
            for (int t2 = 0; t2 < 2; ++t2) {
#pragma unroll
                for (int i = 0; i < 16; ++i) sT[t2][i] = 0.f;
#pragma unroll
                for (int ks = 0; ks < 8; ++ks) { const bf16x8 kf = *(const LAS bf16x8*)(kl + (32 * t2 + n) * P_K + (16 * ks + 8 * hh) * 2); sT[t2] = MFMA32(kf, qf[ks], sT[t2]); }
            }
            const int d0 = (qb - blk) * 256 + 32 * wave + n - 64 * kt;
            const int dmin_wave = (qb - blk) * 256 + 32 * wave - 64 * kt - 63;
            const bool sel = own ? true : ((selmask >> blk) & 1u);
            float mx = -__builtin_inff();
            if (dmin_wave >= 113) {
#pragma unroll
                for (int t2 = 0; t2 < 2; ++t2)
#pragma unroll
                    for (int i = 0; i < 16; ++i) { const float s = sel ? sT[t2][i] + c31 : -__builtin_inff(); sT[t2][i] = s; mx = fmaxf(mx, s); }
            } else {
#pragma unroll
                for (int t2 = 0; t2 < 2; ++t2)
#pragma unroll
                    for (int i = 0; i < 16; ++i) { const int krel = 32 * t2 + (i & 3) + 8 * (i >> 2) + 4 * hh; const int dist = d0 - krel;
                        const int di = dist < 0 ? 0 : (dist > 127 ? 127 : dist);
                        const float s = (sel && dist >= 0) ? sT[t2][i] + BL[di] : -__builtin_inff(); sT[t2][i] = s; mx = fmaxf(mx, s); }
            }
            mx = fmaxf(mx, __shfl_xor(mx, 32));
            const float mnew = fmaxf(mrow, mx);
            const float alpha = exp2f(mrow - mnew);
            mrow = mnew;
            float ls = 0.f;
#pragma unroll
            for (int t2 = 0; t2 < 2; ++t2)
#pragma unroll
                for (int i = 0; i < 16; ++i) { const float p = exp2f(sT[t2][i] - mnew); sT[t2][i] = p; ls += p; }
            lrow = lrow * alpha + ls;
#pragma unroll
            for (int mt = 0; mt < 4; ++mt)
#pragma unroll
                for (int i = 0; i < 16; ++i) oT[mt][i] *= alpha;
#pragma unroll
            for (int t2 = 0; t2 < 2; ++t2)
#pragma unroll
                for (int s = 0; s < 2; ++s) {
                    u32x4 pw; pw.x = pk2(sT[t2][8 * s], sT[t2][8 * s + 1]); pw.y = pk2(sT[t2][8 * s + 2], sT[t2][8 * s + 3]); pw.z = pk2(sT[t2][8 * s + 4], sT[t2][8 * s + 5]); pw.w = pk2(sT[t2][8 * s + 6], sT[t2][8 * s + 7]);
                    const bf16x8 pf8 = __builtin_bit_cast(bf16x8, pw);
                    const int kbase = 32 * t2 + 16 * s + 4 * hh;
#pragma unroll
                    for (int mt = 0; mt < 4; ++mt) { const LAS bf16x4* vp = (const LAS bf16x4*)(vl + (32 * mt + n) * P_V + kbase * 2); const bf16x4 lo = vp[0], hi = vp[2];
                        const bf16x8 vf = __builtin_shufflevector(lo, hi, 0, 1, 2, 3, 4, 5, 6, 7); oT[mt] = MFMA32(vf, pf8, oT[mt]); }
                }
        }
        if (ti + 1 < ntiles) commit((ti + 1) & 1);
        __syncthreads();
    }
    const float ltot = lrow + __shfl_xor(lrow, 32); const float inv = 1.f / ltot;
    bf16* op = oa + (size_t)(tokb + 256 * qb + 32 * wave + n) * 1024 + h * 128;
#pragma unroll
    for (int mt = 0; mt < 4; ++mt)
#pragma unroll
        for (int g4 = 0; g4 < 4; ++g4) { u32x2 o; o.x = pk2(oT[mt][4 * g4] * inv, oT[mt][4 * g4 + 1] * inv); o.y = pk2(oT[mt][4 * g4 + 2] * inv, oT[mt][4 * g4 + 3] * inv);
            *(u32x2*)(op + 32 * mt + 8 * g4 + 4 * hh) = o; }
}


#define TOPK_INSERT(L, v) do { _Pragma("unroll") for (int _i = 15; _i >= 1; --_i) L[_i] = __builtin_amdgcn_fmed3f(L[_i - 1], (v), L[_i]); L[0] = fmaxf(L[0], (v)); } while (0)
DI float pack_idx(float s, unsigned idx, unsigned mask) { return __uint_as_float((__float_as_uint(s) & ~mask) | idx); }
namespace pk {
constexpr int P_K = 272; constexpr int O_KEYS = 0  , O_IDX = 69632  ;
}
DI void peer_topk_phase(const Args& a, LAS unsigned char* lds, int vcu, int G) {
    using namespace pk;
    const int tid = threadIdx.x, lane = tid & 63, wave = __builtin_amdgcn_readfirstlane(tid >> 6); unsigned char* ws = a.ws;
    const int n = lane & 31, hh = lane >> 5;
    const int h = vcu & 7, sub = vcu >> 3, nsub = G >> 3;
    const bf16* skb = (const bf16*)(ws + WS_SK) + (size_t)h * 2 * 128 * 128; const bf16* qry = (const bf16*)(ws + WS_QRY);
    unsigned short* eidx = (unsigned short*)(ws + WS_EIDX); float* gatew = (float*)(ws + WS_GATEW);
    for (int c = tid; c < 2 * 128 * 16; c += 512) { const int row = c >> 4, cc = c & 15; *(LAS u32x4*)(lds + O_KEYS + row * P_K + cc * 16) = *(const u32x4*)(skb + row * 128 + cc * 8); }
    __syncthreads();
    LAS unsigned char* myidx = lds + O_IDX + tid * 32;
    for (int tg = sub * 8 + wave; tg < T / 32; tg += nsub * 8) {
        const int tok = tg * 32 + n;
        float L0[16], L1[16];
#pragma unroll
        for (int i = 0; i < 16; ++i) { L0[i] = -__builtin_inff(); L1[i] = -__builtin_inff(); }
#pragma unroll
        for (int p = 0; p < 2; ++p) {
            bf16x8 qf[8];
            const bf16* qp = qry + (size_t)tok * 2048 + h * 256 + p * 128 + 8 * hh;
#pragma unroll
            for (int ks = 0; ks < 8; ++ks) qf[ks] = *(const bf16x8*)(qp + 16 * ks);
#pragma unroll
            for (int mt = 0; mt < 4; ++mt) {
                f32x16 sc;
#pragma unroll
                for (int i = 0; i < 16; ++i) sc[i] = 0.f;
#pragma unroll
                for (int ks = 0; ks < 8; ++ks) { const bf16x8 kf = *(const LAS bf16x8*)(lds + O_KEYS + (p * 128 + 32 * mt + n) * P_K + (16 * ks + 8 * hh) * 2); sc = MFMA32(kf, qf[ks], sc); }
#pragma unroll
                for (int i = 0; i < 16; ++i) { const unsigned key = 32 * mt + (i & 3) + 8 * (i >> 2) + 4 * hh; const float v = pack_idx(sc[i], key, 127u);
                    if (p == 0) TOPK_INSERT(L0, v); else TOPK_INSERT(L1, v); }
            }
        }
        float A_[16], B_[16];
#pragma unroll
        for (int i = 0; i < 16; ++i) { const float send = hh ? L0[i] : L1[i]; const float recv = __shfl_xor(send, 32); float mine = hh ? L1[i] : L0[i]; A_[i] = mine; B_[i] = recv; }
#pragma unroll
        for (int i = 0; i < 16; ++i) TOPK_INSERT(A_, B_[i]);
        float P0[16], P1[16];
#pragma unroll
        for (int i = 0; i < 16; ++i) { const float o = __shfl_xor(A_[i], 32); P0[i] = hh ? o : A_[i]; P1[i] = hh ? A_[i] : o; }
#pragma unroll
        for (int i = 0; i < 16; ++i) { myidx[i] = (unsigned char)(__float_as_uint(P0[i]) & 127u); myidx[16 + i] = (unsigned char)(__float_as_uint(P1[i]) & 127u); }
        float s0[16], s1[16];
#pragma unroll
        for (int i = 0; i < 16; ++i) { s0[i] = __uint_as_float(__float_as_uint(P0[i]) & ~127u); s1[i] = __uint_as_float(__float_as_uint(P1[i]) & ~127u); }
        float C_[16];
#pragma unroll
        for (int i = 0; i < 16; ++i) C_[i] = -__builtin_inff();
#define CROW(i, jmax) do { _Pragma("unroll") for (int j = 0; j < (jmax); ++j) { const float v = pack_idx(s0[i] + s1[j], (unsigned)((i) * 16 + j), 255u); TOPK_INSERT(C_, v); } } while (0)
        CROW(0, 16); CROW(1, 8); CROW(2, 5); CROW(3, 4); CROW(4, 3); CROW(5, 2); CROW(6, 2); CROW(7, 2);
        CROW(8, 1); CROW(9, 1); CROW(10, 1); CROW(11, 1); CROW(12, 1); CROW(13, 1); CROW(14, 1); CROW(15, 1);
#undef CROW
        float bv[16]; float mx = __uint_as_float(__float_as_uint(C_[0]) & ~255u), den = 0.f;
#pragma unroll
        for (int i = 0; i < 16; ++i) { bv[i] = __expf(__uint_as_float(__float_as_uint(C_[i]) & ~255u) - mx); den += bv[i]; }
        const float rden = 1.f / den;
        asm volatile("s_waitcnt lgkmcnt(0)" ::: "memory");
#pragma unroll
        for (int i = 0; i < 8; ++i) { float c_lo = C_[i], c_hi = C_[8 + i], b_lo = bv[i], b_hi = bv[8 + i];
            asm volatile("" : "+v"(c_lo), "+v"(c_hi), "+v"(b_lo), "+v"(b_hi));
            const float cv = hh ? c_hi : c_lo; const float g = (hh ? b_hi : b_lo) * rden; const unsigned ij = __float_as_uint(cv) & 255u;
            const unsigned k0 = myidx[ij >> 4], k1 = myidx[16 + (ij & 15)];
            const size_t o = (size_t)tok * 128 + h * 16 + hh * 8 + i; eidx[o] = (unsigned short)(k0 * 128 + k1); gatew[o] = g; }
        asm volatile("s_waitcnt lgkmcnt(0)" ::: "memory");
    }
    __syncthreads();
}

DI float dot8(u32x4 a, u32x4 b, float acc) {
    acc += bflo(a.x) * bflo(b.x); acc += bfhi(a.x) * bfhi(b.x); acc += bflo(a.y) * bflo(b.y); acc += bfhi(a.y) * bfhi(b.y);
    acc += bflo(a.z) * bflo(b.z); acc += bfhi(a.z) * bfhi(b.z); acc += bflo(a.w) * bflo(b.w); acc += bfhi(a.w) * bfhi(b.w);
    return acc;
}
DI float gelu_erf(float v) { return 0.5f * v * (1.f + erff(v * 0.70710678118654752f)); }
DI void peer_gather_phase(const Args& a, int vcu, int G) {
    const int tid = threadIdx.x, lane = tid & 63, wave = tid >> 6, gw = vcu * 8 + wave, NGW = G * 8; unsigned char* ws = a.ws;
    const bf16* y1b = (const bf16*)(ws + WS_Y1B); const bf16* ub = (const bf16*)(ws + WS_UB); const bf16* vb = (const bf16*)(ws + WS_VB);
    const unsigned short* eidx = (const unsigned short*)(ws + WS_EIDX); const float* gatew = (const float*)(ws + WS_GATEW); const float* sumsq = (const float*)(ws + WS_SUMSQ2);
    float* out = a.out;
    for (int tok = gw; tok < T; tok += NGW) {
        float rs; { const f32x4* orow = (const f32x4*)(out + (size_t)tok * 2048) + lane; float s = 0.f;
#pragma unroll
            for (int j = 0; j < 8; ++j) { const f32x4 v = orow[64 * j]; s += (v[0] * v[0] + v[1] * v[1]) + (v[2] * v[2] + v[3] * v[3]); }
            s = wave_sum(s); rs = rsqrtf(s * (1.f / D) + EPS); }
        u32x4 hv[4];
#pragma unroll
        for (int c = 0; c < 4; ++c) hv[c] = *((const u32x4*)(y1b + (size_t)tok * 2048) + lane + 64 * c);
        const unsigned e2 = *((const unsigned*)(eidx + (size_t)tok * 128) + lane); const f32x2 g2 = *((const f32x2*)(gatew + (size_t)tok * 128) + lane);
        float coef0 = 0.f, coef1 = 0.f;
        for (int k = 0; k < 128; k += 4) {
            float d[4];
#pragma unroll
            for (int u = 0; u < 4; ++u) { const unsigned ew = (unsigned)__builtin_amdgcn_readlane((int)e2, (k + u) >> 1); const unsigned e = ((k + u) & 1) ? (ew >> 16) : (ew & 0xffffu);
                const u32x4* up = (const u32x4*)(ub + (size_t)e * 2048) + lane; float s = 0.f;
#pragma unroll
                for (int c = 0; c < 4; ++c) s = dot8(hv[c], up[64 * c], s);
                d[u] = s; }
#pragma unroll
            for (int u = 0; u < 4; ++u) { const float s = wave_sum(d[u]); const int owner = (k + u) >> 1; if (lane == owner) { if ((k + u) & 1) coef1 = s; else coef0 = s; } }
        }
        coef0 = g2[0] * gelu_erf(coef0 * rs); coef1 = g2[1] * gelu_erf(coef1 * rs);
        float acc[4][8];
#pragma unroll
        for (int c = 0; c < 4; ++c)
#pragma unroll
            for (int j = 0; j < 8; ++j) acc[c][j] = 0.f;
        for (int k = 0; k < 128; k += 2) {
#pragma unroll
            for (int u = 0; u < 2; ++u) { const unsigned ew = (unsigned)__builtin_amdgcn_readlane((int)e2, k >> 1); const unsigned e = u ? (ew >> 16) : (ew & 0xffffu);
                const float cf = __uint_as_float((unsigned)__builtin_amdgcn_readlane((int)__float_as_uint(u ? coef1 : coef0), k >> 1));
                const u32x4* vp = (const u32x4*)(vb + (size_t)e * 2048) + lane;
#pragma unroll
                for (int c = 0; c < 4; ++c) { const u32x4 w = vp[64 * c];
                    acc[c][0] += cf * bflo(w.x); acc[c][1] += cf * bfhi(w.x); acc[c][2] += cf * bflo(w.y); acc[c][3] += cf * bfhi(w.y);
                    acc[c][4] += cf * bflo(w.z); acc[c][5] += cf * bfhi(w.z); acc[c][6] += cf * bflo(w.w); acc[c][7] += cf * bfhi(w.w); } }
        }
        float* op = out + (size_t)tok * 2048;
#pragma unroll
        for (int c = 0; c < 4; ++c) { f32x4* p4 = (f32x4*)(op + 8 * (lane + 64 * c)); f32x4 y0 = p4[0], y1 = p4[1];
            y0 += PSCALE * (f32x4){acc[c][0], acc[c][1], acc[c][2], acc[c][3]}; y1 += PSCALE * (f32x4){acc[c][4], acc[c][5], acc[c][6], acc[c][7]}; p4[0] = y0; p4[1] = y1; }
    }
}

__global__ void __launch_bounds__(512, 2) fwd_kernel(Args args) {
    extern __shared__ __attribute__((aligned(16))) unsigned char lds_raw[];
    LAS unsigned char* lds = (LAS unsigned char*)lds_raw;
    cg::grid_group grid = cg::this_grid();
    const int G = gridDim.x; const int bx = blockIdx.x; const int vcu = (G % 8 == 0) ? (bx % 8) * (G / 8) + bx / 8 : bx;
    unsigned char* ws = args.ws;
    const int lo = args.ph_lo, hi = args.ph_hi;
#ifndef PH_MASK
#define PH_MASK 0xffff
#endif
#define IN(k) (((PH_MASK >> (k)) & 1) && lo <= (k) && (k) < hi)
#define SEAM(k) do { if (IN(k) && IN((k) + 1)) grid.sync(); } while (0)
    if (IN(0)) { phase0(args, lds, vcu, G); }
    SEAM(0);
    if (IN(1)) {
        phase_ba(args, vcu, G);
        __syncthreads();
        { pg8::Gemm g{(const bf16*)(ws + WS_XB), (const bf16*)(ws + WS_WINA), T, 6144, D}; pg8::StaticOrder S; S.init(T, 6144, G, bx);
          EpiProjA E{(bf16*)(ws + WS_QKA), (bf16*)(ws + WS_QKVB), (bf16*)(ws + WS_ZB), (const float*)(ws + WS_RSTD1)};
          pg8::gemm_phase<EpiProjA>(lds, g, S, E); }
        { pg8::Gemm g{(const bf16*)(ws + WS_WINA) + (size_t)6144 * D, (const bf16*)(ws + WS_XB), 1024, T, D}; pg8::StaticOrder S; S.init(1024, T, G, bx);
          EpiProjV E{(bf16*)(ws + WS_VT), (const float*)(ws + WS_RSTD1)};
          pg8::gemm_phase<EpiProjV>(lds, g, S, E); }
    }
    SEAM(1);
    if (IN(2)) {
        for (int u = vcu; u < 64; u += G) moba_prep_unit(args, lds, u);
        for (int u = vcu; u < 2048; u += G) gdn_prep_unit(args, lds, u);
        if (bx == 0 && threadIdx.x == 0) *(unsigned*)(ws + WS_CTL) = 0u;
    }
    SEAM(2);
    if (IN(3)) {
        if (vcu < 64) gdn_scan_unit(args, lds, vcu);
        LAS unsigned* qw = (LAS unsigned*)(lds + 147200);
        for (;;) {
            __syncthreads();
            if (threadIdx.x == 0) *qw = atomicAdd((unsigned*)(ws + WS_CTL), 1u);
            __syncthreads();
            const unsigned u = *qw;
            if (u >= 512u) break;
            moba_attn_unit(args, lds, (int)u);
        }
    }
    SEAM(3);
    if (IN(4)) {
        pg8::Gemm g{(const bf16*)(ws + WS_XB), (const bf16*)(ws + WS_WINB), T, 4096, D}; pg8::StaticOrder S; S.init(T, 4096, G, bx);
        EpiGate E{(bf16*)(ws + WS_G), (const float*)(ws + WS_RSTD1)};
        pg8::gemm_phase<EpiGate>(lds, g, S, E);
    }
    SEAM(4);
    if (IN(5)) {
        { pg8::Gemm g{(const bf16*)(ws + WS_OA), (const bf16*)(ws + WS_WUPA), T, 2048, 1024}; pg8::StaticOrder S; S.init(T, 2048, G, bx);
          EpiUp<0> E{(const bf16*)(ws + WS_G), (bf16*)(ws + WS_PP), (bf16*)(ws + WS_MERGED)};
          pg8::gemm_phase<EpiUp<0>>(lds, g, S, E); }
        { pg8::Gemm g{(const bf16*)(ws + WS_OB), (const bf16*)(ws + WS_WUPB), T, 2048, 1024}; pg8::StaticOrder S; S.init(T, 2048, G, bx);
          EpiUp<1> E{(const bf16*)(ws + WS_G), (bf16*)(ws + WS_PP), (bf16*)(ws + WS_MERGED)};
          pg8::gemm_phase<EpiUp<1>>(lds, g, S, E); }
    }
    SEAM(5);
    if (IN(6)) {
        pg8::Gemm g{(const bf16*)(ws + WS_MERGED), (const bf16*)(ws + WS_WOUT), T, 2048, D}; pg8::StaticOrder S; S.init(T, 2048, G, bx);
        EpiOut E{args.in[I_X], args.out, (bf16*)(ws + WS_Y1B), (float*)(ws + WS_SUMSQ2)};
        pg8::gemm_phase<EpiOut>(lds, g, S, E);
        phase_tables(args, vcu, G);
    }
    SEAM(6);
    if (IN(7)) {
        pg8::Gemm g{(const bf16*)(ws + WS_Y1B), (const bf16*)(ws + WS_WQ), T, 2048, D}; pg8::StaticOrder S; S.init(T, 2048, G, bx);
        EpiQry E{(bf16*)(ws + WS_QRY), (const float*)(ws + WS_SUMSQ2)};
        pg8::gemm_phase<EpiQry>(lds, g, S, E);
    }
    SEAM(7);
    if (IN(8)) peer_topk_phase(args, lds, vcu, G);
    SEAM(8);
    if (IN(9)) peer_gather_phase(args, vcu, G);
#undef IN
#undef SEAM
}

extern "C" void kernel_launch(void* const* d_in, const int* in_sizes, int n_in, void* d_out, int out_size, void* d_ws, size_t ws_size, hipStream_t stream) {
    static int grid = 0;
    if (grid == 0) {
        int dev = 0, cus = 0, per_cu = 0;
        (void)hipGetDevice(&dev);
        (void)hipDeviceGetAttribute(&cus, hipDeviceAttributeMultiprocessorCount, dev);
        (void)hipFuncSetAttribute((const void*)fwd_kernel, hipFuncAttributeMaxDynamicSharedMemorySize, LDS_BYTES);
        (void)hipOccupancyMaxActiveBlocksPerMultiprocessor(&per_cu, (const void*)fwd_kernel, 512, LDS_BYTES);
        if (n_in != 18 || ws_size < WS_END) { fprintf(stderr, "kernel_launch: unexpected n_in %d or ws_size %zu\n", n_in, ws_size); grid = -1; return; }
        grid = (per_cu >= 1) ? cus : 0;
        if (grid <= 0) { fprintf(stderr, "kernel_launch: occupancy query failed (%d)\n", per_cu); grid = -1; return; }
    }
    if (grid < 0) return;
    Args a{};
    for (int i = 0; i < 18; ++i) a.in[i] = (const float*)d_in[i];
    a.out = (float*)d_out; a.ws = (unsigned char*)d_ws;
    a.ph_lo = 0; a.ph_hi = 100;
    void* kargs[] = {&a};
    hipError_t e = hipLaunchCooperativeKernel((const void*)fwd_kernel, dim3(grid), dim3(512), kargs, LDS_BYTES, stream);
    if (e != hipSuccess) fprintf(stderr, "cooperative launch failed: %s\n", hipGetErrorString(e));
}
```
